# Optimizing an MI355X kernel written in HIP

```python
import math
import jax, jax.numpy as jnp
from jax import lax
import numpy as np

D_MODEL = 1024
BATCH = 8
SEQ = 2048
DEPTH = 1
DEC_BATCH = 32
DEC_SEQ = 8
PAST_LEN = 16384
PAGE_SIZE = 128

MLA_HEADS = 8
QK_NOPE_DIM = 64
ROPE_DIM = 32
V_HEAD_DIM = 64
Q_RANK = 256
KV_RANK = 256
ROPE_THETA = 10000.0
D_ATTN = MLA_HEADS * V_HEAD_DIM
D_MIX = D_MODEL
D_SSM = D_MIX - D_ATTN
SSM_CH = 16
SSM_GROUPS = D_SSM // SSM_CH
SSM_STATE = 64
D_IN = Q_RANK + KV_RANK + ROPE_DIM + D_SSM
N_MEM = 256
MEM_HEADS = 4
MEM_HEAD_DIM = 128
D_FF = 2816
CONV_W = 3

Q_BLOCK = 128
EPS = 1e-6
ATTN_SCALE = (QK_NOPE_DIM + ROPE_DIM) ** -0.5
MEM_SCALE = MEM_HEAD_DIM ** -0.5

kernel_name = 'hybrid_mla_s5_memxattn_convffn_step'

F32 = jnp.float32


def rmsnorm(x, g):
    xf = x.astype(F32)
    y = xf * lax.rsqrt(jnp.mean(xf * xf, axis=-1, keepdims=True) + EPS)
    return (y * g.astype(F32)).astype(x.dtype)


def rope(x, pos):
    half = ROPE_DIM // 2
    inv = ROPE_THETA ** (-jnp.arange(half, dtype=F32) * (2.0 / ROPE_DIM))
    ang = pos.astype(F32)[:, None] * inv[None, :]
    shape = (ang.shape[0],) + (1,) * (x.ndim - 3) + (half,)
    cos = jnp.cos(ang).reshape(shape)
    sin = jnp.sin(ang).reshape(shape)
    xf = x.astype(F32)
    x1, x2 = xf[..., :half], xf[..., half:]
    return jnp.concatenate([x1 * cos - x2 * sin, x1 * sin + x2 * cos], axis=-1).astype(x.dtype)


def attend(q_lat, q_pe, q_pos, k_lat, k_pe, k_pos):
    b, l, h, r = q_lat.shape
    blk = min(Q_BLOCK, l)
    nb = l // blk
    ql = q_lat.reshape(b, nb, blk, h, r).transpose(1, 0, 2, 3, 4)
    qp = q_pe.reshape(b, nb, blk, h, ROPE_DIM).transpose(1, 0, 2, 3, 4)
    qpos = q_pos.reshape(nb, blk)

    def one_block(args):
        ql_b, qp_b, pos_b = args
        s = (jnp.einsum('bqhr,bkr->bhqk', ql_b, k_lat)
             + jnp.einsum('bqhe,bke->bhqk', qp_b, k_pe)).astype(F32) * ATTN_SCALE
        mask = k_pos[None, :] <= pos_b[:, None]
        s = jnp.where(mask[None, None], s, -jnp.inf)
        pr = jax.nn.softmax(s, axis=-1).astype(k_lat.dtype)
        return jnp.einsum('bhqk,bkr->bqhr', pr, k_lat)

    o = lax.map(one_block, (ql, qp, qpos))
    return o.transpose(1, 0, 2, 3, 4).reshape(b, l, h, r)


def mla_mixer(c_q, c_kv, k_r, pos, p, past):
    b, l, _ = c_q.shape
    c_kv = rmsnorm(c_kv, p['kv_norm'])
    k_r = rope(k_r, pos)
    q = jnp.einsum('blr,rhe->blhe', rmsnorm(c_q, p['q_norm']), p['w_uq'])
    q_nope = q[..., :QK_NOPE_DIM]
    q_pe = rope(q[..., QK_NOPE_DIM:], pos)
    q_lat = jnp.einsum('blhd,rhd->blhr', q_nope, p['w_uk'])
    if past is None:
        keys_lat, keys_pe = c_kv, k_r
    else:
        keys_lat = jnp.concatenate([past[0], c_kv], axis=1)
        keys_pe = jnp.concatenate([past[1], k_r], axis=1)
    k_pos = jnp.arange(keys_lat.shape[1], dtype=jnp.int32)
    o_lat = attend(q_lat, q_pe, pos, keys_lat, keys_pe, k_pos)
    out = jnp.einsum('blhr,rhv->blhv', o_lat, p['w_uv']).reshape(b, l, D_ATTN)
    return out, c_kv, k_r


def _cmul_combine(e1, e2):
    a1r, a1i, b1r, b1i = e1
    a2r, a2i, b2r, b2i = e2
    ar = a2r * a1r - a2i * a1i
    ai = a2r * a1i + a2i * a1r
    br = a2r * b1r - a2i * b1i + b2r
    bi = a2r * b1i + a2i * b1r + b2i
    return ar, ai, br, bi


def s5_mixer(u, p, h0):
    b, l, _ = u.shape
    uf = u.astype(F32)
    ug = uf.reshape(b, l, SSM_GROUPS, SSM_CH)
    a_re = p['ssm_a_re'].astype(F32)
    a_im = p['ssm_a_im'].astype(F32)
    dt = jnp.exp(p['ssm_log_dt'].astype(F32))[:, None]
    mag = jnp.exp(dt * a_re)
    abr = mag * jnp.cos(dt * a_im)
    abi = mag * jnp.sin(dt * a_im)
    den = a_re * a_re + a_im * a_im
    nr, ni = abr - 1.0, abi
    fr = (nr * a_re + ni * a_im) / den
    fi = (ni * a_re - nr * a_im) / den
    b_re = p['ssm_b_re'].astype(F32)
    b_im = p['ssm_b_im'].astype(F32)
    bbr = fr[..., None] * b_re - fi[..., None] * b_im
    bbi = fr[..., None] * b_im + fi[..., None] * b_re
    bur = jnp.einsum('blgc,gnc->blgn', ug, bbr)
    bui = jnp.einsum('blgc,gnc->blgn', ug, bbi)
    if h0 is not None:
        h0r = h0[0].astype(F32)
        h0i = h0[1].astype(F32)
        bur = bur.at[:, 0].add(abr * h0r - abi * h0i)
        bui = bui.at[:, 0].add(abr * h0i + abi * h0r)
    a_r = jnp.broadcast_to(abr, bur.shape)
    a_i = jnp.broadcast_to(abi, bui.shape)
    _, _, hr, hi = lax.associative_scan(_cmul_combine, (a_r, a_i, bur, bui), axis=1)
    y = (jnp.einsum('blgn,gcn->blgc', hr, p['ssm_c_re'].astype(F32))
         - jnp.einsum('blgn,gcn->blgc', hi, p['ssm_c_im'].astype(F32)))
    y = y.reshape(b, l, D_SSM) + p['ssm_d'].astype(F32) * uf
    g = jax.nn.gelu(y)
    out = g * jax.nn.sigmoid(g @ p['ssm_w_glu'].astype(F32))
    return out.astype(u.dtype), hr[:, -1], hi[:, -1]


def mem_kv(mem, p):
    m = rmsnorm(mem, p['mem_norm'])
    b, n, _ = m.shape
    k = (m @ p['w_k_mem']).reshape(b, n, MEM_HEADS, MEM_HEAD_DIM)
    v = (m @ p['w_v_mem']).reshape(b, n, MEM_HEADS, MEM_HEAD_DIM)
    return k, v


def mem_attend(h, mk, mv, p):
    b, l, _ = h.shape
    q = (h @ p['w_q_mem']).reshape(b, l, MEM_HEADS, MEM_HEAD_DIM)
    s = jnp.einsum('blhd,bmhd->bhlm', q, mk).astype(F32) * MEM_SCALE
    pr = jax.nn.softmax(s, axis=-1).astype(mv.dtype)
    o = jnp.einsum('bhlm,bmhd->blhd', pr, mv).reshape(b, l, MEM_HEADS * MEM_HEAD_DIM)
    return o @ p['w_o_mem']


def conv_ffn(h, p, conv_prev):
    b, l, _ = h.shape
    g = h @ p['w_gate']
    up = h @ p['w_up']
    if conv_prev is None:
        conv_prev = jnp.zeros((b, CONV_W - 1, D_FF), g.dtype)
    gp = jnp.concatenate([conv_prev.astype(g.dtype), g], axis=1)
    w = p['ffn_conv_w']
    gc = p['ffn_conv_b'] + sum(w[k] * gp[:, k:k + l] for k in range(CONV_W))
    out = (jax.nn.silu(gc) * up) @ p['w_down']
    return out, gp[:, -(CONV_W - 1):]


def layer(x, pos, mk, mv, p, past_kv, ssm_h0, conv_prev):
    h = rmsnorm(x, p['norm_mix_pre'])
    z = h @ p['w_in']
    o1 = Q_RANK
    o2 = o1 + KV_RANK
    o3 = o2 + ROPE_DIM
    c_q, c_kv, k_r, u = z[..., :o1], z[..., o1:o2], z[..., o2:o3], z[..., o3:]
    attn_out, c_kv_n, k_r_n = mla_mixer(c_q, c_kv, k_r, pos, p, past_kv)
    ssm_out, hr, hi = s5_mixer(u, p, ssm_h0)
    mix = jnp.concatenate([rmsnorm(attn_out, p['norm_attn_out']),
                           rmsnorm(ssm_out, p['norm_ssm_out'])], axis=-1) @ p['w_out']
    x = x + rmsnorm(mix, p['norm_mix_post'])
    h = rmsnorm(x, p['norm_mem_pre'])
    x = x + rmsnorm(mem_attend(h, mk, mv, p), p['norm_mem_post'])
    h = rmsnorm(x, p['norm_ffn_pre'])
    f, conv_new = conv_ffn(h, p, conv_prev)
    x = x + rmsnorm(f, p['norm_ffn_post'])
    return x, c_kv_n, k_r_n, hr, hi, conv_new


def setup_inputs(seed: int = 0) -> dict:
    key = jax.random.key(seed)
    ks = iter(jax.random.split(key, 64))

    def nrm(shape, scale=1.0):
        return scale * jax.random.normal(next(ks), shape, F32)

    def gain(n):
        return 1.0 + 0.05 * nrm((DEPTH, n))

    n_pages = PAST_LEN // PAGE_SIZE
    n_used = DEC_BATCH * n_pages
    n_pool = n_used + n_used // 4
    perm = jax.random.permutation(next(ks), n_pool)[:n_used]
    page_table = perm.reshape(DEC_BATCH, n_pages).astype(jnp.int32)
    n_idx = jnp.arange(SSM_STATE, dtype=F32)
    G, N, C = SSM_GROUPS, SSM_STATE, SSM_CH
    return {
        'x_prompt': nrm((BATCH, SEQ, D_MODEL)),
        'x_sample': nrm((DEC_BATCH, DEC_SEQ, D_MODEL)),
        'mem_prompt': nrm((BATCH, N_MEM, D_MODEL)),
        'cache_kv_latent': nrm((DEPTH, n_pool, PAGE_SIZE, KV_RANK)),
        'cache_k_rope': nrm((DEPTH, n_pool, PAGE_SIZE, ROPE_DIM)),
        'page_table': page_table,
        'state_ssm_re': nrm((DEPTH, DEC_BATCH, G, N), 0.3),
        'state_ssm_im': nrm((DEPTH, DEC_BATCH, G, N), 0.3),
        'state_ffn_conv': nrm((DEPTH, DEC_BATCH, CONV_W - 1, D_FF)),
        'cache_mem_k': nrm((DEPTH, DEC_BATCH, N_MEM, MEM_HEADS, MEM_HEAD_DIM)),
        'cache_mem_v': nrm((DEPTH, DEC_BATCH, N_MEM, MEM_HEADS, MEM_HEAD_DIM)),
        'norm_mix_pre': gain(D_MODEL),
        'w_in': nrm((DEPTH, D_MODEL, D_IN), D_MODEL ** -0.5),
        'q_norm': gain(Q_RANK),
        'kv_norm': gain(KV_RANK),
        'w_uq': nrm((DEPTH, Q_RANK, MLA_HEADS, QK_NOPE_DIM + ROPE_DIM), Q_RANK ** -0.5),
        'w_uk': nrm((DEPTH, KV_RANK, MLA_HEADS, QK_NOPE_DIM), KV_RANK ** -0.5),
        'w_uv': nrm((DEPTH, KV_RANK, MLA_HEADS, V_HEAD_DIM), KV_RANK ** -0.5),
        'ssm_a_re': -0.5 + 0.01 * nrm((DEPTH, G, N)),
        'ssm_a_im': math.pi * n_idx + 0.01 * nrm((DEPTH, G, N)),
        'ssm_log_dt': jax.random.uniform(next(ks), (DEPTH, G), F32, math.log(1e-3), math.log(1e-1)),
        'ssm_b_re': nrm((DEPTH, G, N, C), C ** -0.5),
        'ssm_b_im': nrm((DEPTH, G, N, C), C ** -0.5),
        'ssm_c_re': nrm((DEPTH, G, C, N), N ** -0.5),
        'ssm_c_im': nrm((DEPTH, G, C, N), N ** -0.5),
        'ssm_d': nrm((DEPTH, D_SSM)),
        'ssm_w_glu': nrm((DEPTH, D_SSM, D_SSM), D_SSM ** -0.5),
        'norm_attn_out': gain(D_ATTN),
        'norm_ssm_out': gain(D_SSM),
        'w_out': nrm((DEPTH, D_MIX, D_MODEL), D_MIX ** -0.5),
        'norm_mix_post': gain(D_MODEL),
        'norm_mem_pre': gain(D_MODEL),
        'mem_norm': gain(D_MODEL),
        'w_q_mem': nrm((DEPTH, D_MODEL, MEM_HEADS * MEM_HEAD_DIM), D_MODEL ** -0.5),
        'w_k_mem': nrm((DEPTH, D_MODEL, MEM_HEADS * MEM_HEAD_DIM), D_MODEL ** -0.5),
        'w_v_mem': nrm((DEPTH, D_MODEL, MEM_HEADS * MEM_HEAD_DIM), D_MODEL ** -0.5),
        'w_o_mem': nrm((DEPTH, MEM_HEADS * MEM_HEAD_DIM, D_MODEL), (MEM_HEADS * MEM_HEAD_DIM) ** -0.5),
        'norm_mem_post': gain(D_MODEL),
        'norm_ffn_pre': gain(D_MODEL),
        'w_gate': nrm((DEPTH, D_MODEL, D_FF), D_MODEL ** -0.5),
        'w_up': nrm((DEPTH, D_MODEL, D_FF), D_MODEL ** -0.5),
        'ffn_conv_w': nrm((DEPTH, CONV_W, D_FF), CONV_W ** -0.5),
        'ffn_conv_b': nrm((DEPTH, D_FF), 0.02),
        'w_down': nrm((DEPTH, D_FF, D_MODEL), D_FF ** -0.5),
        'norm_ffn_post': gain(D_MODEL),
    }


def reference(x_prompt, x_sample, mem_prompt, cache_kv_latent, cache_k_rope, page_table,
              state_ssm_re, state_ssm_im, state_ffn_conv, cache_mem_k, cache_mem_v,
              norm_mix_pre, w_in, q_norm, kv_norm, w_uq, w_uk, w_uv,
              ssm_a_re, ssm_a_im, ssm_log_dt, ssm_b_re, ssm_b_im, ssm_c_re, ssm_c_im,
              ssm_d, ssm_w_glu, norm_attn_out, norm_ssm_out, w_out, norm_mix_post,
              norm_mem_pre, mem_norm, w_q_mem, w_k_mem, w_v_mem, w_o_mem, norm_mem_post,
              norm_ffn_pre, w_gate, w_up, ffn_conv_w, ffn_conv_b, w_down, norm_ffn_post):
    weights = dict(
        norm_mix_pre=norm_mix_pre, w_in=w_in, q_norm=q_norm, kv_norm=kv_norm,
        w_uq=w_uq, w_uk=w_uk, w_uv=w_uv, ssm_a_re=ssm_a_re, ssm_a_im=ssm_a_im,
        ssm_log_dt=ssm_log_dt, ssm_b_re=ssm_b_re, ssm_b_im=ssm_b_im, ssm_c_re=ssm_c_re,
        ssm_c_im=ssm_c_im, ssm_d=ssm_d, ssm_w_glu=ssm_w_glu, norm_attn_out=norm_attn_out,
        norm_ssm_out=norm_ssm_out, w_out=w_out, norm_mix_post=norm_mix_post,
        norm_mem_pre=norm_mem_pre, mem_norm=mem_norm, w_q_mem=w_q_mem, w_k_mem=w_k_mem,
        w_v_mem=w_v_mem, w_o_mem=w_o_mem, norm_mem_post=norm_mem_post,
        norm_ffn_pre=norm_ffn_pre, w_gate=w_gate, w_up=w_up, ffn_conv_w=ffn_conv_w,
        ffn_conv_b=ffn_conv_b, w_down=w_down, norm_ffn_post=norm_ffn_post)
    db = x_sample.shape[0]
    past_len = page_table.shape[1] * cache_kv_latent.shape[2]
    pos_p = jnp.arange(x_prompt.shape[1], dtype=jnp.int32)
    pos_s = past_len + jnp.arange(x_sample.shape[1], dtype=jnp.int32)

    xp, xs = x_prompt, x_sample
    p_kv, p_kr, p_sr, p_si, p_cv, p_mk, p_mv = [], [], [], [], [], [], []
    s_kv, s_kr, s_sr, s_si, s_cv = [], [], [], [], []
    for l in range(DEPTH):
        p = {name: w[l] for name, w in weights.items()}
        mk, mv = mem_kv(mem_prompt, p)
        xp, ckv, kr, hr, hi, cv = layer(xp, pos_p, mk, mv, p, None, None, None)
        p_kv.append(ckv); p_kr.append(kr); p_sr.append(hr); p_si.append(hi)
        p_cv.append(cv); p_mk.append(mk); p_mv.append(mv)
        past_lat = jnp.take(cache_kv_latent[l], page_table, axis=0).reshape(db, past_len, KV_RANK)
        past_pe = jnp.take(cache_k_rope[l], page_table, axis=0).reshape(db, past_len, ROPE_DIM)
        xs, ckv, kr, hr, hi, cv = layer(
            xs, pos_s, cache_mem_k[l], cache_mem_v[l], p, (past_lat, past_pe),
            (state_ssm_re[l], state_ssm_im[l]), state_ffn_conv[l])
        s_kv.append(ckv); s_kr.append(kr); s_sr.append(hr); s_si.append(hi); s_cv.append(cv)

    return (xp, xs,
            jnp.stack(p_kv), jnp.stack(p_kr), jnp.stack(p_sr), jnp.stack(p_si),
            jnp.stack(p_cv), jnp.stack(p_mk), jnp.stack(p_mv),
            jnp.stack(s_kv), jnp.stack(s_kr), jnp.stack(s_sr), jnp.stack(s_si),
            jnp.stack(s_cv))
```

```cpp
#include <hip/hip_runtime.h>
#include <cstdio>
#include <cstdint>
#include <cmath>
namespace nv {
constexpr int TP = 16384, TS = 256, TT = TP + TS;
constexpr int DM = 1024, DIN = 1056, DFF = 2816;
constexpr float EPS = 1e-6f;

__global__ void __launch_bounds__(256) gemm(const float* A, long lda, const float* B, long sbk, long sbn, float* C, long ldc,
                                            int M, int N, int K, long bsA, long bsB, long bsC) {
    __shared__ float As[16][65], Bs[16][65];
    A += (long)blockIdx.z * bsA; B += (long)blockIdx.z * bsB; C += (long)blockIdx.z * bsC;
    const int tid = threadIdx.x, tx = tid & 15, ty = tid >> 4;
    const int m0 = blockIdx.y * 64, n0 = blockIdx.x * 64;
    float acc[4][4] = {};
    for (int k0 = 0; k0 < K; k0 += 16) {
#pragma unroll
        for (int i = 0; i < 4; ++i) {
            int idx = tid + i * 256; int r = idx >> 4, kk = idx & 15;
            As[kk][r] = (m0 + r < M && k0 + kk < K) ? A[(long)(m0 + r) * lda + k0 + kk] : 0.f;
            int kb = idx >> 6, n = idx & 63;
            Bs[kb][n] = (n0 + n < N && k0 + kb < K) ? B[(long)(k0 + kb) * sbk + (long)(n0 + n) * sbn] : 0.f;
        }
        __syncthreads();
#pragma unroll
        for (int kk = 0; kk < 16; ++kk) {
            float a[4], b[4];
#pragma unroll
            for (int i = 0; i < 4; ++i) { a[i] = As[kk][ty * 4 + i]; b[i] = Bs[kk][tx * 4 + i]; }
#pragma unroll
            for (int i = 0; i < 4; ++i)
#pragma unroll
                for (int j = 0; j < 4; ++j) acc[i][j] += a[i] * b[j];
        }
        __syncthreads();
    }
#pragma unroll
    for (int i = 0; i < 4; ++i)
#pragma unroll
        for (int j = 0; j < 4; ++j) { int m = m0 + ty * 4 + i, n = n0 + tx * 4 + j; if (m < M && n < N) C[(long)m * ldc + n] = acc[i][j]; }
}
static void launch_gemm(hipStream_t s, const float* A, long lda, const float* B, long sbk, long sbn, float* C, long ldc, int M, int N, int K,
                        int batch = 1, long bsA = 0, long bsB = 0, long bsC = 0) {
    dim3 g((N + 63) / 64, (M + 63) / 64, batch);
    gemm<<<g, 256, 0, s>>>(A, lda, B, sbk, sbn, C, ldc, M, N, K, bsA, bsB, bsC);
}

__global__ void __launch_bounds__(256) rmsnorm(const float* in, long ldi, const float* gain, const float* base, long ldb, float* out, long ldo, int rows, int width) {
    const int row = blockIdx.x * 4 + (threadIdx.x >> 6), lane = threadIdx.x & 63;
    if (row >= rows) return;
    const float* x = in + (long)row * ldi;
    float s = 0.f;
    for (int c = lane; c < width; c += 64) s += x[c] * x[c];
    for (int o = 32; o; o >>= 1) s += __shfl_xor(s, o);
    const float r = rsqrtf(s / (float)width + EPS);
    for (int c = lane; c < width; c += 64) { float v = x[c] * r * gain[c]; if (base) v += base[(long)row * ldb + c]; out[(long)row * ldo + c] = v; }
}
static void launch_rms(hipStream_t s, const float* in, long ldi, const float* gain, const float* base, long ldb, float* out, long ldo, int rows, int width) {
    rmsnorm<<<(rows + 3) / 4, 256, 0, s>>>(in, ldi, gain, base, ldb, out, ldo, rows, width);
}
__device__ __forceinline__ int tok_pos(int t) { return t < TP ? (t & 2047) : 16384 + ((t - TP) & 7); }
__global__ void rope32(const float* in, long ldi, float* out, long ldo, int nheads, long hstride, int T) {
    long i = (long)blockIdx.x * blockDim.x + threadIdx.x;
    if (i >= (long)T * nheads * 16) return;
    int j = (int)(i & 15); long th = i >> 4; int h = (int)(th % nheads); int t = (int)(th / nheads);
    const double inv = pow(10000.0, -(double)j / 16.0);
    const double ang = (double)tok_pos(t) * (double)(float)inv;
    const float c = (float)cos(ang), sn = (float)sin(ang);
    const float* p = in + (long)t * ldi + (long)h * hstride; float* q = out + (long)t * ldo + (long)h * hstride;
    const float x1 = p[j], x2 = p[j + 16];
    q[j] = x1 * c - x2 * sn; q[j + 16] = x1 * sn + x2 * c;
}
__global__ void __launch_bounds__(256) attn(const float* Q, long ldq, long hq, const float* K, long ldk, long hk, const float* V, long ldv, long hv,
                                            const float* K2, const float* V2, float* O, long ldo, long ho, int dq, int dv, float scale, int mode, int q_off) {
    extern __shared__ float sm[];
    const int qi = blockIdx.x + q_off, h = blockIdx.y, tid = threadIdx.x;
    const float* Kb; const float* Vb; int nk;
    if (mode == 0) { int b = qi >> 11, i = qi & 2047; Kb = K + (long)b * 2048 * ldk; Vb = V + (long)b * 2048 * ldv; nk = i + 1; }
    else if (mode == 1) { int b = (qi - TP) >> 3, l = (qi - TP) & 7; Kb = K + (long)b * 16392 * ldk; Vb = V + (long)b * 16392 * ldv; nk = 16384 + l + 1; }
    else { if (qi < TP) { int b = qi >> 11; Kb = K + (long)b * 256 * ldk; Vb = V + (long)b * 256 * ldv; } else { int b = (qi - TP) >> 3; Kb = K2 + (long)b * 256 * ldk; Vb = V2 + (long)b * 256 * ldv; } nk = 256; }
    const int NKMAX = (mode == 1) ? 16392 : 2048;
    float* sc = sm; float* red = sm + NKMAX; float* qv = red + 256;
    const float* q = Q + (long)qi * ldq + (long)h * hq;
    for (int d = tid; d < dq; d += 256) qv[d] = q[d];
    __syncthreads();
    float mx = -INFINITY;
    for (int j = tid; j < nk; j += 256) { const float* k = Kb + (long)j * ldk + (long)h * hk; float s = 0.f; for (int d = 0; d < dq; ++d) s += qv[d] * k[d]; s *= scale; sc[j] = s; mx = fmaxf(mx, s); }
    red[tid] = mx; __syncthreads();
    for (int o = 128; o; o >>= 1) { if (tid < o) red[tid] = fmaxf(red[tid], red[tid + o]); __syncthreads(); }
    mx = red[0]; __syncthreads();
    float sum = 0.f;
    for (int j = tid; j < nk; j += 256) { float p = expf(sc[j] - mx); sc[j] = p; sum += p; }
    red[tid] = sum; __syncthreads();
    for (int o = 128; o; o >>= 1) { if (tid < o) red[tid] += red[tid + o]; __syncthreads(); }
    sum = red[0]; __syncthreads();
    const int parts = 256 / dv, d = tid % dv, part = tid / dv;
    float acc = 0.f;
    if (part < parts) for (int j = part; j < nk; j += parts) acc += sc[j] * Vb[(long)j * ldv + (long)h * hv + d];
    red[tid] = acc; __syncthreads();
    if (tid < dv) { float a = 0.f; for (int p = 0; p < parts; ++p) a += red[p * dv + tid]; O[(long)qi * ldo + (long)h * ho + tid] = a / sum; }
}
__global__ void build_kcat(const float* KN, const float* KR, float* Kc, int T) {
    long i = (long)blockIdx.x * blockDim.x + threadIdx.x; if (i >= (long)T * 768) return;
    int c = (int)(i % 768); long t = i / 768; int h = c / 96, d = c % 96;
    Kc[i] = d < 64 ? KN[t * 512 + h * 64 + d] : KR[t * 32 + d - 64];
}
__global__ void build_kabs(const float* clat, const float* cpe, const int* pt, const float* CKV, const float* KR, float* Ka) {
    long i = (long)blockIdx.x * blockDim.x + threadIdx.x; if (i >= 32L * 16392 * 288) return;
    int c = (int)(i % 288); long bj = i / 288; int j = (int)(bj % 16392), b = (int)(bj / 16392);
    float v;
    if (j < 16384) { int page = pt[b * 128 + (j >> 7)], off = j & 127; v = c < 256 ? clat[((long)page * 128 + off) * 256 + c] : cpe[((long)page * 128 + off) * 32 + c - 256]; }
    else { long t = TP + b * 8 + (j - 16384); v = c < 256 ? CKV[t * 256 + c] : KR[t * 32 + c - 256]; }
    Ka[i] = v;
}
__global__ void s5_prep(const float* a_re, const float* a_im, const float* log_dt, const float* b_re, const float* b_im, float* abr, float* abi, float* bbr, float* bbi) {
    int i = blockIdx.x * blockDim.x + threadIdx.x; if (i >= 32 * 64) return;
    int g = i >> 6;
    float dt = expf(log_dt[g]); float are = a_re[i], aim = a_im[i];
    float mag = expf(dt * are); float br = mag * cosf(dt * aim), bi = mag * sinf(dt * aim);
    abr[i] = br; abi[i] = bi;
    float den = are * are + aim * aim; float nr = br - 1.f, ni = bi;
    float fr = (nr * are + ni * aim) / den, fi = (ni * are - nr * aim) / den;
    for (int c = 0; c < 16; ++c) { float xr = b_re[i * 16 + c], xi = b_im[i * 16 + c]; bbr[i * 16 + c] = fr * xr - fi * xi; bbi[i * 16 + c] = fr * xi + fi * xr; }
}
__global__ void __launch_bounds__(64) s5_scan(const float* U, long ldu, const float* abr, const float* abi, const float* bbr, const float* bbi,
                                              const float* c_re, const float* c_im, const float* h0r, const float* h0i, float* Y, float* outr_p, float* outi_p, float* outr_s, float* outi_s) {
    __shared__ float sh[128];
    const int seq = blockIdx.x, g = blockIdx.y, n = threadIdx.x;
    const int L = seq < 8 ? 2048 : 8; const long t0 = seq < 8 ? (long)seq * 2048 : TP + (long)(seq - 8) * 8;
    const int gi = g * 64 + n;
    const float ar = abr[gi], ai = abi[gi];
    float br_[16], bi_[16];
    for (int c = 0; c < 16; ++c) { br_[c] = bbr[gi * 16 + c]; bi_[c] = bbi[gi * 16 + c]; }
    const int cc = n & 15, q = n >> 4;
    float cr_[16], ci_[16];
    for (int k = 0; k < 16; ++k) { cr_[k] = c_re[(g * 16 + cc) * 64 + q * 16 + k]; ci_[k] = c_im[(g * 16 + cc) * 64 + q * 16 + k]; }
    float hr = 0.f, hi = 0.f;
    if (seq >= 8) { hr = h0r[((seq - 8) * 32 + g) * 64 + n]; hi = h0i[((seq - 8) * 32 + g) * 64 + n]; }
    for (int t = 0; t < L; ++t) {
        const float* u = U + (t0 + t) * ldu + g * 16;
        float bur = 0.f, bui = 0.f;
#pragma unroll
        for (int c = 0; c < 16; ++c) { float uv = u[c]; bur += br_[c] * uv; bui += bi_[c] * uv; }
        float nr = ar * hr - ai * hi + bur, ni = ar * hi + ai * hr + bui;
        hr = nr; hi = ni;
        sh[n] = hr; sh[64 + n] = hi;
        __syncthreads();
        float y = 0.f;
#pragma unroll
        for (int k = 0; k < 16; ++k) y += sh[q * 16 + k] * cr_[k] - sh[64 + q * 16 + k] * ci_[k];
        y += __shfl_xor(y, 16); y += __shfl_xor(y, 32);
        if (n < 16) Y[(t0 + t) * 512 + g * 16 + n] = y;
        __syncthreads();
    }
    if (seq < 8) { outr_p[(seq * 32 + g) * 64 + n] = hr; outi_p[(seq * 32 + g) * 64 + n] = hi; }
    else { outr_s[((seq - 8) * 32 + g) * 64 + n] = hr; outi_s[((seq - 8) * 32 + g) * 64 + n] = hi; }
}
__device__ __forceinline__ float gelu_tanh(float x) { return 0.5f * x * (1.f + tanhf(0.7978845608028654f * (x + 0.044715f * x * x * x))); }
__device__ __forceinline__ float sigmoidf_(float x) { return 1.f / (1.f + expf(-x)); }
__global__ void s5_gelu(const float* Y, const float* U, long ldu, const float* Dv, float* G, int T) {
    long i = (long)blockIdx.x * blockDim.x + threadIdx.x; if (i >= (long)T * 512) return;
    int c = (int)(i & 511); long t = i >> 9;
    G[i] = gelu_tanh(Y[i] + Dv[c] * U[t * ldu + c]);
}
__global__ void glu_mul(const float* G, const float* GG, float* O, long n) { long i = (long)blockIdx.x * blockDim.x + threadIdx.x; if (i < n) O[i] = G[i] * sigmoidf_(GG[i]); }
__global__ void conv_act(const float* GATE, const float* UP, const float* cw, const float* cb, const float* prev_s, float* ACT, int T) {
    long i = (long)blockIdx.x * blockDim.x + threadIdx.x; if (i >= (long)T * DFF) return;
    int c = (int)(i % DFF); int t = (int)(i / DFF);
    int l; float g1, g2;
    if (t < TP) { l = t & 2047; g1 = l >= 1 ? GATE[i - DFF] : 0.f; g2 = l >= 2 ? GATE[i - 2 * DFF] : 0.f; }
    else { int ts = t - TP; int b = ts >> 3; l = ts & 7;
        g1 = l >= 1 ? GATE[i - DFF] : prev_s[((long)b * 2 + 1) * DFF + c];
        g2 = l >= 2 ? GATE[i - 2 * DFF] : prev_s[((long)b * 2 + l) * DFF + c]; }
    float gc = cb[c] + cw[c] * g2 + cw[DFF + c] * g1 + cw[2 * DFF + c] * GATE[i];
    ACT[i] = gc * sigmoidf_(gc) * UP[i];
}
__global__ void conv_state_out(const float* GATE, float* outp, float* outs) {
    int i = blockIdx.x * blockDim.x + threadIdx.x;
    if (i < 8 * 2 * DFF) { int c = i % DFF, r = (i / DFF) & 1, b = i / (2 * DFF); outp[i] = GATE[((long)b * 2048 + 2046 + r) * DFF + c]; }
    if (i < 32 * 2 * DFF) { int c = i % DFF, r = (i / DFF) & 1, b = i / (2 * DFF); outs[i] = GATE[((long)TP + b * 8 + 6 + r) * DFF + c]; }
}
__global__ void copy_cols(const float* in, long ldi, float* out, long ldo, int rows, int cols) {
    long i = (long)blockIdx.x * blockDim.x + threadIdx.x; if (i >= (long)rows * cols) return;
    int c = (int)(i % cols); long r = i / cols; out[r * ldo + c] = in[r * ldi + c];
}

struct Bufs {
    float *X, *H, *Z, *CQN, *CKV, *KR, *Q, *KN, *VV, *KC, *QABS, *KABS, *OLAT, *AO, *CAT, *ABR, *ABI, *BBR, *BBI, *Y, *G, *GG, *SO, *MIX, *X1, *H2, *QM, *HM, *MK, *MV, *OM, *MO, *X2, *H3, *GATE, *UP, *ACT, *F;
};
static Bufs carve(float* ws) {
    Bufs b; size_t o = 0; auto take = [&](size_t n) { float* p = ws + o; o += (n + 63) & ~(size_t)63; return p; };
    b.X = take((size_t)TT * DM); b.H = take((size_t)TT * DM); b.Z = take((size_t)TT * DIN); b.CQN = take((size_t)TT * 256); b.CKV = take((size_t)TT * 256); b.KR = take((size_t)TT * 32);
    b.Q = take((size_t)TT * 768); b.KN = take((size_t)TP * 512); b.VV = take((size_t)TP * 512); b.KC = take((size_t)TP * 768);
    b.QABS = take((size_t)TS * 8 * 288); b.KABS = take((size_t)32 * 16392 * 288); b.OLAT = take((size_t)TS * 8 * 256); b.AO = take((size_t)TT * 512); b.CAT = take((size_t)TT * 1024);
    b.ABR = take(2048); b.ABI = take(2048); b.BBR = take(32768); b.BBI = take(32768); b.Y = take((size_t)TT * 512); b.G = take((size_t)TT * 512); b.GG = take((size_t)TT * 512); b.SO = take((size_t)TT * 512);
    b.MIX = take((size_t)TT * DM); b.X1 = take((size_t)TT * DM); b.H2 = take((size_t)TT * DM); b.QM = take((size_t)TT * 512); b.HM = take((size_t)2048 * DM); b.MK = take((size_t)2048 * 512); b.MV = take((size_t)2048 * 512);
    b.OM = take((size_t)TT * 512); b.MO = take((size_t)TT * DM); b.X2 = take((size_t)TT * DM); b.H3 = take((size_t)TT * DM); b.GATE = take((size_t)TT * DFF); b.UP = take((size_t)TT * DFF); b.ACT = take((size_t)TT * DFF); b.F = take((size_t)TT * DM);
    return b;
}
constexpr size_t O_YP = 0, O_YS = 16777216, O_KVP = O_YS + 262144, O_KRP = O_KVP + 4194304, O_SRP = O_KRP + 524288, O_SIP = O_SRP + 16384, O_FCP = O_SIP + 16384,
                 O_MKP = O_FCP + 45056, O_MVP = O_MKP + 1048576, O_KVS = O_MVP + 1048576, O_KRS = O_KVS + 65536, O_SRS = O_KRS + 8192, O_SIS = O_SRS + 65536, O_FCS = O_SIS + 65536, O_END = O_FCS + 180224;

static void run(void* const* d_in, float* out, float* ws, hipStream_t s) {
    auto I = [&](int i) { return (const float*)d_in[i]; };
    Bufs b = carve(ws);
    hipMemcpyAsync(b.X, d_in[0], (size_t)TP * DM * 4, hipMemcpyDeviceToDevice, s);
    hipMemcpyAsync(b.X + (size_t)TP * DM, d_in[1], (size_t)TS * DM * 4, hipMemcpyDeviceToDevice, s);
    launch_rms(s, b.X, DM, I(11), nullptr, 0, b.H, DM, TT, DM);
    launch_gemm(s, b.H, DM, I(12), DIN, 1, b.Z, DIN, TT, DIN, DM);
    launch_rms(s, b.Z, DIN, I(13), nullptr, 0, b.CQN, 256, TT, 256);
    launch_rms(s, b.Z + 256, DIN, I(14), nullptr, 0, b.CKV, 256, TT, 256);
    rope32<<<(TT * 16 + 255) / 256, 256, 0, s>>>(b.Z + 512, DIN, b.KR, 32, 1, 0, TT);
    hipMemcpyAsync(out + O_KVP, b.CKV, (size_t)TP * 256 * 4, hipMemcpyDeviceToDevice, s);
    hipMemcpyAsync(out + O_KVS, b.CKV + (size_t)TP * 256, (size_t)TS * 256 * 4, hipMemcpyDeviceToDevice, s);
    hipMemcpyAsync(out + O_KRP, b.KR, (size_t)TP * 32 * 4, hipMemcpyDeviceToDevice, s);
    hipMemcpyAsync(out + O_KRS, b.KR + (size_t)TP * 32, (size_t)TS * 32 * 4, hipMemcpyDeviceToDevice, s);
    launch_gemm(s, b.CQN, 256, I(15), 768, 1, b.Q, 768, TT, 768, 256);
    rope32<<<(TT * 8 * 16 + 255) / 256, 256, 0, s>>>(b.Q + 64, 768, b.Q + 64, 768, 8, 96, TT);
    launch_gemm(s, b.CKV, 256, I(16), 512, 1, b.KN, 512, TP, 512, 256);
    launch_gemm(s, b.CKV, 256, I(17), 512, 1, b.VV, 512, TP, 512, 256);
    build_kcat<<<(int)(((long)TP * 768 + 255) / 256), 256, 0, s>>>(b.KN, b.KR, b.KC, TP);
    const float ascale = 1.0f / sqrtf(96.f);
    attn<<<dim3(TP, 8), 256, (2048 + 256 + 288) * 4, s>>>(b.Q, 768, 96, b.KC, 768, 96, b.VV, 512, 64, nullptr, nullptr, b.AO, 512, 64, 96, 64, ascale, 0, 0);
    launch_gemm(s, b.Q + (size_t)TP * 768, 768, I(16), 1, 512, b.QABS, 8 * 288, TS, 256, 64, 8, 96, 64, 288);
    for (int h = 0; h < 8; ++h) copy_cols<<<(TS * 32 + 255) / 256, 256, 0, s>>>(b.Q + (size_t)TP * 768 + h * 96 + 64, 768, b.QABS + h * 288 + 256, 8 * 288, TS, 32);
    build_kabs<<<(int)((32L * 16392 * 288 + 255) / 256), 256, 0, s>>>(I(3), I(4), (const int*)d_in[5], b.CKV, b.KR, b.KABS);
    attn<<<dim3(TS, 8), 256, (16392 + 256 + 288) * 4, s>>>(b.QABS - (size_t)TP * 8 * 288, 8 * 288, 288, b.KABS, 288, 0, b.KABS, 288, 0, nullptr, nullptr, b.OLAT - (size_t)TP * 8 * 256, 8 * 256, 256, 288, 256, ascale, 1, TP);
    launch_gemm(s, b.OLAT, 8 * 256, I(17), 512, 1, b.AO + (size_t)TP * 512, 512, TS, 64, 256, 8, 256, 64, 64);
    launch_rms(s, b.AO, 512, I(27), nullptr, 0, b.CAT, 1024, TT, 512);
    s5_prep<<<8, 256, 0, s>>>(I(18), I(19), I(20), I(21), I(22), b.ABR, b.ABI, b.BBR, b.BBI);
    s5_scan<<<dim3(40, 32), 64, 0, s>>>(b.Z + 544, DIN, b.ABR, b.ABI, b.BBR, b.BBI, I(23), I(24), I(6), I(7), b.Y, out + O_SRP, out + O_SIP, out + O_SRS, out + O_SIS);
    s5_gelu<<<(int)(((long)TT * 512 + 255) / 256), 256, 0, s>>>(b.Y, b.Z + 544, DIN, I(25), b.G, TT);
    launch_gemm(s, b.G, 512, I(26), 512, 1, b.GG, 512, TT, 512, 512);
    glu_mul<<<(int)(((long)TT * 512 + 255) / 256), 256, 0, s>>>(b.G, b.GG, b.SO, (long)TT * 512);
    launch_rms(s, b.SO, 512, I(28), nullptr, 0, b.CAT + 512, 1024, TT, 512);
    launch_gemm(s, b.CAT, 1024, I(29), DM, 1, b.MIX, DM, TT, DM, 1024);
    launch_rms(s, b.MIX, DM, I(30), b.X, DM, b.X1, DM, TT, DM);
    launch_rms(s, b.X1, DM, I(31), nullptr, 0, b.H2, DM, TT, DM);
    launch_gemm(s, b.H2, DM, I(33), 512, 1, b.QM, 512, TT, 512, DM);
    launch_rms(s, I(2), DM, I(32), nullptr, 0, b.HM, DM, 2048, DM);
    launch_gemm(s, b.HM, DM, I(34), 512, 1, out + O_MKP, 512, 2048, 512, DM);
    launch_gemm(s, b.HM, DM, I(35), 512, 1, out + O_MVP, 512, 2048, 512, DM);
    attn<<<dim3(TT, 4), 256, (2048 + 256 + 288) * 4, s>>>(b.QM, 512, 128, out + O_MKP, 512, 128, out + O_MVP, 512, 128, I(9), I(10), b.OM, 512, 128, 128, 128, 1.0f / sqrtf(128.f), 2, 0);
    launch_gemm(s, b.OM, 512, I(36), DM, 1, b.MO, DM, TT, DM, 512);
    launch_rms(s, b.MO, DM, I(37), b.X1, DM, b.X2, DM, TT, DM);
    launch_rms(s, b.X2, DM, I(38), nullptr, 0, b.H3, DM, TT, DM);
    launch_gemm(s, b.H3, DM, I(39), DFF, 1, b.GATE, DFF, TT, DFF, DM);
    launch_gemm(s, b.H3, DM, I(40), DFF, 1, b.UP, DFF, TT, DFF, DM);
    conv_act<<<(int)(((long)TT * DFF + 255) / 256), 256, 0, s>>>(b.GATE, b.UP, I(41), I(42), I(8), b.ACT, TT);
    conv_state_out<<<(32 * 2 * DFF + 255) / 256, 256, 0, s>>>(b.GATE, out + O_FCP, out + O_FCS);
    launch_gemm(s, b.ACT, DFF, I(43), DM, 1, b.F, DM, TT, DM, DFF);
    launch_rms(s, b.F, DM, I(44), b.X2, DM, out + O_YP, DM, TP, DM);
    launch_rms(s, b.F + (size_t)TP * DM, DM, I(44), b.X2 + (size_t)TP * DM, DM, out + O_YS, DM, TS, DM);
}
}
extern "C" void kernel_launch(void* const* d_in, const int* in_sizes, int n_in,
                              void* d_out, int out_size, void* d_ws, size_t ws_size,
                              hipStream_t stream) {
    static int inited = 0;
    if (!inited) { inited = 1; hipFuncSetAttribute((const void*)nv::attn, hipFuncAttributeMaxDynamicSharedMemorySize, (16392 + 256 + 288) * 4); }
    nv::run(d_in, (float*)d_out, (float*)d_ws, stream);
}
```
